# Optimizing an MI355X kernel written in HIP

```python
import math
import jax, jax.numpy as jnp
from jax import lax
import numpy as np

D_MODEL = 1024
BATCH = 8
SEQ = 2048
DEPTH = 1

DIFF_HEADS = 4
DIFF_QK_DIM = 64
DIFF_V_DIM = 2 * DIFF_QK_DIM
DIFF_WIDTH = DIFF_HEADS * DIFF_V_DIM
MOBA_HEADS = 8
MOBA_HEAD_DIM = 64
MOBA_WIDTH = MOBA_HEADS * MOBA_HEAD_DIM
MOBA_BLOCK = 256
MOBA_TOPK = 3
MOBA_Q_CHUNK = 16
MIX_WIDTH = DIFF_WIDTH + MOBA_WIDTH
IN_WIDTH = 4 * DIFF_WIDTH + 4 * MOBA_WIDTH
N_BUCKETS = 32
MAX_DISTANCE = 128
N_BIAS_HEADS = DIFF_HEADS + MOBA_HEADS
Q_BLOCK = 128
NORM_EPS = 1e-6
SUBLN_EPS = 1e-5
NEG = -1e30

kernel_name = "hymba_diff_moba_hybrid"


def rmsnorm(x, g, eps=NORM_EPS):
    xf = x.astype(jnp.float32)
    ms = jnp.mean(xf * xf, axis=-1, keepdims=True)
    return (xf * lax.rsqrt(ms + eps) * g.astype(jnp.float32)).astype(x.dtype)


def rel_bucket(dist):
    n = jnp.maximum(dist, 0)
    max_exact = N_BUCKETS // 2
    nf = jnp.maximum(n, 1).astype(jnp.float32)
    large = max_exact + (jnp.log(nf / max_exact) / math.log(MAX_DISTANCE / max_exact)
                         * (N_BUCKETS - max_exact)).astype(jnp.int32)
    large = jnp.minimum(large, N_BUCKETS - 1)
    return jnp.where(n < max_exact, n, large)


def diff_attention(q, k, v, lam, lambda_init, subln_g, bias_tab):
    B, H, S = q.shape[0], q.shape[1], q.shape[2]
    scale = DIFF_QK_DIM ** -0.5
    nqb = S // Q_BLOCK
    q_blocks = jnp.moveaxis(q.reshape(B, H, nqb, Q_BLOCK, 2, DIFF_QK_DIM), 2, 0)
    k_pos = jnp.arange(S)

    def one_block(args):
        qb, blk = args
        q_pos = blk * Q_BLOCK + jnp.arange(Q_BLOCK)
        dist = q_pos[:, None] - k_pos[None, :]
        bias = jnp.moveaxis(bias_tab[rel_bucket(dist)], -1, 0)
        logits = jnp.einsum('bhqcd,bhkcd->bhcqk', qb, k).astype(jnp.float32) * scale
        logits = logits + bias[None, :, None].astype(jnp.float32)
        logits = jnp.where(dist >= 0, logits, -jnp.inf)
        p = jax.nn.softmax(logits, axis=-1)
        w = p[:, :, 0] - lam * p[:, :, 1]
        return jnp.einsum('bhqk,bhkd->bhqd', w.astype(v.dtype), v)

    out = lax.map(one_block, (q_blocks, jnp.arange(nqb)))
    out = jnp.moveaxis(out, 0, 2).reshape(B, H, S, DIFF_V_DIM)
    return rmsnorm(out, subln_g, SUBLN_EPS) * (1.0 - lambda_init)


def moba_attention(q, k, v, bias_tab):
    B, H, S, D = q.shape
    scale = D ** -0.5
    nb = -(-S // MOBA_BLOCK)
    pad = nb * MOBA_BLOCK - S
    kp = jnp.pad(k, ((0, 0), (0, 0), (0, pad), (0, 0)))
    vp = jnp.pad(v, ((0, 0), (0, 0), (0, pad), (0, 0)))
    kb = kp.reshape(B, H, nb, MOBA_BLOCK, D)
    vb = vp.reshape(B, H, nb, MOBA_BLOCK, D)
    k_mean = jnp.mean(kb.astype(jnp.float32), axis=3)
    top = max(1, min(MOBA_TOPK, nb - 1))
    bias_flat = bias_tab.T.reshape(-1)
    head_off = (jnp.arange(H) * N_BUCKETS)[None, :, None, None, None]
    nc = S // MOBA_Q_CHUNK
    q_chunks = jnp.moveaxis(q.reshape(B, H, nc, MOBA_Q_CHUNK, D), 2, 0)
    gather_blocks = jax.vmap(jax.vmap(lambda blocks, idx: blocks[idx]))
    blk_off = jnp.arange(MOBA_BLOCK)

    def one_chunk(args):
        qb, ci = args
        t0 = ci * MOBA_Q_CHUNK
        q_pos = t0 + jnp.arange(MOBA_Q_CHUNK)
        cur = t0 // MOBA_BLOCK
        gate = jnp.einsum('bhqd,bhnd->bhqn', qb.astype(jnp.float32), k_mean)
        gate = jnp.where(jnp.arange(nb) < cur, gate, NEG)
        _, idx = lax.top_k(gate, top)
        valid = idx < cur
        k_sel = gather_blocks(kb, idx)
        v_sel = gather_blocks(vb, idx)
        k_sel_pos = idx[..., None] * MOBA_BLOCK + blk_off
        s_sel = jnp.einsum('bhqd,bhqtkd->bhqtk', qb, k_sel).astype(jnp.float32) * scale
        dist_sel = q_pos[:, None, None] - k_sel_pos
        s_sel = s_sel + bias_flat[head_off + rel_bucket(dist_sel)].astype(jnp.float32)
        s_sel = jnp.where(valid[..., None], s_sel, -jnp.inf)
        s_sel = s_sel.reshape(B, H, MOBA_Q_CHUNK, top * MOBA_BLOCK)
        k_own = lax.dynamic_slice_in_dim(kb, cur, 1, axis=2)[:, :, 0]
        v_own = lax.dynamic_slice_in_dim(vb, cur, 1, axis=2)[:, :, 0]
        dist_own = q_pos[:, None] - (cur * MOBA_BLOCK + blk_off)[None, :]
        bias_own = jnp.moveaxis(bias_tab[rel_bucket(dist_own)], -1, 0)
        s_own = jnp.einsum('bhqd,bhkd->bhqk', qb, k_own).astype(jnp.float32) * scale
        s_own = s_own + bias_own[None].astype(jnp.float32)
        s_own = jnp.where(dist_own >= 0, s_own, -jnp.inf)
        p = jax.nn.softmax(jnp.concatenate([s_sel, s_own], axis=-1), axis=-1)
        p_sel = p[..., :top * MOBA_BLOCK].reshape(B, H, MOBA_Q_CHUNK, top, MOBA_BLOCK)
        p_own = p[..., top * MOBA_BLOCK:]
        return (jnp.einsum('bhqtk,bhqtkd->bhqd', p_sel.astype(v.dtype), v_sel)
                + jnp.einsum('bhqk,bhkd->bhqd', p_own.astype(v.dtype), v_own))

    out = lax.map(one_chunk, (q_chunks, jnp.arange(nc)))
    return jnp.moveaxis(out, 0, 2).reshape(B, H, S, D)


def setup_inputs(seed: int = 0) -> dict:
    key = jax.random.key(seed)
    ks = jax.random.split(key, 8)
    x = jax.random.normal(ks[0], (BATCH, SEQ, D_MODEL), jnp.float32)
    norm_pre_g = 1.0 + 0.02 * jax.random.normal(ks[1], (DEPTH, D_MODEL), jnp.float32)
    w_in = jax.random.normal(ks[2], (DEPTH, D_MODEL, IN_WIDTH), jnp.float32) * D_MODEL ** -0.5
    diff_lambda = 0.1 * jax.random.normal(ks[3], (DEPTH, 4, DIFF_QK_DIM), jnp.float32)
    diff_subln_g = 1.0 + 0.02 * jax.random.normal(ks[4], (DEPTH, DIFF_V_DIM), jnp.float32)
    w_out = jax.random.normal(ks[5], (DEPTH, MIX_WIDTH, D_MODEL), jnp.float32) * MIX_WIDTH ** -0.5
    norm_post_g = 1.0 + 0.02 * jax.random.normal(ks[6], (DEPTH, D_MODEL), jnp.float32)
    rel_bias = 0.2 * jax.random.normal(ks[7], (N_BUCKETS, N_BIAS_HEADS), jnp.float32)
    return {"x": x, "norm_pre_g": norm_pre_g, "w_in": w_in, "diff_lambda": diff_lambda,
            "diff_subln_g": diff_subln_g, "w_out": w_out, "norm_post_g": norm_post_g,
            "rel_bias": rel_bias}


def reference(x, norm_pre_g, w_in, diff_lambda, diff_subln_g, w_out, norm_post_g, rel_bias):
    B, S, _ = x.shape
    splits = [DIFF_WIDTH, 2 * DIFF_WIDTH, 3 * DIFF_WIDTH, 4 * DIFF_WIDTH,
              4 * DIFF_WIDTH + MOBA_WIDTH, 4 * DIFF_WIDTH + 2 * MOBA_WIDTH,
              4 * DIFF_WIDTH + 3 * MOBA_WIDTH]
    bias_diff = rel_bias[:, :DIFF_HEADS]
    bias_moba = rel_bias[:, DIFF_HEADS:]
    for layer in range(DEPTH):
        h = rmsnorm(x, norm_pre_g[layer])
        u = jnp.einsum('bsd,de->bse', h, w_in[layer])
        dq, dk, dv, dg, mq, mk, mv, mg = jnp.split(u, splits, axis=-1)
        lambda_init = 0.8 - 0.6 * math.exp(-0.3 * layer)
        lp = diff_lambda[layer].astype(jnp.float32)
        lam = jnp.exp(jnp.sum(lp[0] * lp[1])) - jnp.exp(jnp.sum(lp[2] * lp[3])) + lambda_init
        to_qk = lambda t: jnp.transpose(t.reshape(B, S, DIFF_HEADS, 2, DIFF_QK_DIM), (0, 2, 1, 3, 4))
        dvh = jnp.transpose(dv.reshape(B, S, DIFF_HEADS, DIFF_V_DIM), (0, 2, 1, 3))
        a_out = diff_attention(to_qk(dq), to_qk(dk), dvh, lam, lambda_init,
                               diff_subln_g[layer], bias_diff)
        a_out = jnp.transpose(a_out, (0, 2, 1, 3)).reshape(B, S, DIFF_WIDTH) * jax.nn.silu(dg)
        to_h = lambda t: jnp.transpose(t.reshape(B, S, MOBA_HEADS, MOBA_HEAD_DIM), (0, 2, 1, 3))
        b_out = moba_attention(to_h(mq), to_h(mk), to_h(mv), bias_moba)
        b_out = jnp.transpose(b_out, (0, 2, 1, 3)).reshape(B, S, MOBA_WIDTH) * jax.nn.silu(mg)
        y = jnp.einsum('bse,ed->bsd', jnp.concatenate([a_out, b_out], axis=-1), w_out[layer])
        x = x + rmsnorm(y, norm_post_g[layer])
    return x
```

```cpp
#include <hip/hip_runtime.h>
#include <cstdint>
#include <cmath>

constexpr int BATCH = 8, SEQ = 2048, DM = 1024, M = BATCH * SEQ, INW = 4096;
constexpr int DH = 4, DQK = 64, DV = 128, MH = 8, MD = 64, MBLK = 256, NBLK = SEQ / MBLK;
constexpr int C_DQ = 0, C_DK = 512, C_DV = 1024, C_DG = 1536, C_MQ = 2048, C_MK = 2560, C_MV = 3072, C_MG = 3584;

typedef unsigned short bf16_t;
__device__ __forceinline__ bf16_t f2bf(float f) { unsigned u = __builtin_bit_cast(unsigned, f); return (bf16_t)((u + 0x7fffu + ((u >> 16) & 1u)) >> 16); }
__device__ __forceinline__ float bf2f(bf16_t h) { return __builtin_bit_cast(float, (unsigned)h << 16); }

__device__ __forceinline__ int rel_bucket(int dist) {
    int n = dist < 0 ? 0 : dist;
    if (n < 16) return n;
    float nf = (float)n;
    int large = 16 + (int)(logf(nf / 16.0f) / logf(8.0f) * 16.0f);
    return large < 31 ? large : 31;
}

__device__ __forceinline__ float block_sum(float v, float* red) {
    for (int o = 32; o > 0; o >>= 1) v += __shfl_xor(v, o);
    __syncthreads();
    if ((threadIdx.x & 63) == 0) red[threadIdx.x >> 6] = v;
    __syncthreads();
    float s = 0.f;
    for (int i = 0; i < (int)(blockDim.x >> 6); ++i) s += red[i];
    return s;
}
__device__ __forceinline__ float block_max(float v, float* red) {
    for (int o = 32; o > 0; o >>= 1) v = fmaxf(v, __shfl_xor(v, o));
    __syncthreads();
    if ((threadIdx.x & 63) == 0) red[threadIdx.x >> 6] = v;
    __syncthreads();
    float s = -INFINITY;
    for (int i = 0; i < (int)(blockDim.x >> 6); ++i) s = fmaxf(s, red[i]);
    return s;
}

__global__ void k_rowscale(const float* x, float* r) {
    __shared__ float red[8];
    const int m = blockIdx.x;
    float s = 0.f;
    for (int i = threadIdx.x; i < DM; i += blockDim.x) { float v = x[(size_t)m * DM + i]; s += v * v; }
    s = block_sum(s, red);
    if (threadIdx.x == 0) r[m] = 1.0f / sqrtf(s / DM + 1e-6f);
}

template <int MODE>
__global__ void __launch_bounds__(256) k_gemm(const void* Ap, const float* g, const float* rs, const float* W, int K, int N, bf16_t* U, float* QKF, float* Y) {
    __shared__ float As[16][132];
    __shared__ float Bs[16][132];
    const int tid = threadIdx.x, tx = tid & 15, ty = tid >> 4;
    const int m0 = blockIdx.y * 128, n0 = blockIdx.x * 128;
    float acc[8][8];
#pragma unroll
    for (int i = 0; i < 8; ++i)
#pragma unroll
        for (int j = 0; j < 8; ++j) acc[i][j] = 0.f;
    for (int k0 = 0; k0 < K; k0 += 16) {
#pragma unroll
        for (int i = 0; i < 8; ++i) {
            const int e = tid + i * 256, row = e >> 4, kk = e & 15;
            float v;
            if (MODE == 0) v = ((const float*)Ap)[(size_t)(m0 + row) * K + k0 + kk] * g[k0 + kk];
            else v = bf2f(((const bf16_t*)Ap)[(size_t)(m0 + row) * K + k0 + kk]);
            As[kk][row] = v;
        }
#pragma unroll
        for (int i = 0; i < 8; ++i) {
            const int e = tid + i * 256, kk = e >> 7, col = e & 127;
            Bs[kk][col] = W[(size_t)(k0 + kk) * N + n0 + col];
        }
        __syncthreads();
#pragma unroll
        for (int kk = 0; kk < 16; ++kk) {
            float a[8], b[8];
#pragma unroll
            for (int i = 0; i < 8; ++i) a[i] = As[kk][ty * 8 + i];
#pragma unroll
            for (int j = 0; j < 8; ++j) b[j] = Bs[kk][tx * 8 + j];
#pragma unroll
            for (int i = 0; i < 8; ++i)
#pragma unroll
                for (int j = 0; j < 8; ++j) acc[i][j] = fmaf(a[i], b[j], acc[i][j]);
        }
        __syncthreads();
    }
#pragma unroll
    for (int i = 0; i < 8; ++i) {
        const int row = m0 + ty * 8 + i;
        const float r = (MODE == 0) ? rs[row] : 1.0f;
#pragma unroll
        for (int j = 0; j < 8; ++j) {
            const int col = n0 + tx * 8 + j;
            const float v = acc[i][j] * r;
            if (MODE == 0) {
                U[(size_t)row * N + col] = f2bf(v);
                if (col >= C_MQ && col < C_MV) QKF[(size_t)row * 1024 + (col - C_MQ)] = v;
            } else Y[(size_t)row * N + col] = v;
        }
    }
}

__global__ void k_kmean(const float* QKF, float* kmean) {
    const int idx = blockIdx.x;
    const int n = idx % NBLK, h = (idx / NBLK) % MH, b = idx / (NBLK * MH);
    const int d = threadIdx.x;
    float s = 0.f;
    for (int t = 0; t < MBLK; ++t) s += QKF[(size_t)(b * SEQ + n * MBLK + t) * 1024 + 512 + h * MD + d];
    kmean[(size_t)idx * MD + d] = s / (float)MBLK;
}

__global__ void __launch_bounds__(256) k_diff(const bf16_t* U, const float* lam_p, const float* subg, const float* rel_bias, bf16_t* mix) {
    __shared__ float lg[2][SEQ];
    __shared__ float qs[2][DQK];
    __shared__ float btab[130];
    __shared__ float red[8];
    __shared__ float osum[2][DV];
    const int q = blockIdx.x % SEQ, h = (blockIdx.x / SEQ) % DH, b = blockIdx.x / (SEQ * DH);
    const int tid = threadIdx.x;
    const size_t rowq = (size_t)(b * SEQ + q) * INW;
    if (tid < 128) qs[tid >> 6][tid & 63] = bf2f(U[rowq + C_DQ + h * 128 + tid]);
    if (tid < 129) btab[tid] = rel_bias[rel_bucket(tid) * 12 + h];
    float lam;
    {
        float s01 = 0.f, s23 = 0.f;
        for (int i = 0; i < 64; ++i) { s01 += lam_p[i] * lam_p[64 + i]; s23 += lam_p[128 + i] * lam_p[192 + i]; }
        lam = expf(s01) - expf(s23) + 0.2f;
    }
    __syncthreads();
    const int nk = q + 1;
    float mx0 = -INFINITY, mx1 = -INFINITY;
    for (int k = tid; k < nk; k += 256) {
        const bf16_t* kr = U + (size_t)(b * SEQ + k) * INW + C_DK + h * 128;
        float s0 = 0.f, s1 = 0.f;
        for (int d = 0; d < 64; ++d) { s0 += qs[0][d] * bf2f(kr[d]); s1 += qs[1][d] * bf2f(kr[64 + d]); }
        int dist = q - k; if (dist > 128) dist = 128;
        const float bb = btab[dist];
        s0 = s0 * 0.125f + bb; s1 = s1 * 0.125f + bb;
        lg[0][k] = s0; lg[1][k] = s1;
        mx0 = fmaxf(mx0, s0); mx1 = fmaxf(mx1, s1);
    }
    mx0 = block_max(mx0, red); mx1 = block_max(mx1, red);
    float l0 = 0.f, l1 = 0.f;
    for (int k = tid; k < nk; k += 256) {
        const float p0 = expf(lg[0][k] - mx0), p1 = expf(lg[1][k] - mx1);
        lg[0][k] = p0; lg[1][k] = p1; l0 += p0; l1 += p1;
    }
    l0 = block_sum(l0, red); l1 = block_sum(l1, red);
    for (int k = tid; k < nk; k += 256) lg[0][k] = lg[0][k] / l0 - lam * (lg[1][k] / l1);
    __syncthreads();
    const int d = tid & 127, half = tid >> 7;
    float o = 0.f;
    for (int k = half; k < nk; k += 2) o += lg[0][k] * bf2f(U[(size_t)(b * SEQ + k) * INW + C_DV + h * 128 + d]);
    osum[half][d] = o;
    __syncthreads();
    float ov = 0.f, sq = 0.f;
    if (tid < 128) { ov = osum[0][tid] + osum[1][tid]; sq = ov * ov; }
    sq = block_sum(sq, red);
    if (tid < 128) {
        const float rn = 1.0f / sqrtf(sq / 128.0f + 1e-5f);
        float val = ov * rn * subg[tid] * 0.8f;
        const float gt = bf2f(U[rowq + C_DG + h * 128 + tid]);
        val *= gt / (1.0f + expf(-gt));
        mix[(size_t)(b * SEQ + q) * 1024 + h * 128 + tid] = f2bf(val);
    }
}

__global__ void __launch_bounds__(256) k_moba(const bf16_t* U, const float* QKF, const float* kmean, const float* rel_bias, bf16_t* mix) {
    __shared__ float lg[4 * MBLK];
    __shared__ int kpos[4 * MBLK];
    __shared__ float qs[MD];
    __shared__ float btab[130];
    __shared__ float red[8];
    __shared__ float osum[4][MD];
    __shared__ int sel[3];
    __shared__ int nsel_s;
    __shared__ float gate_s[NBLK];
    const int q = blockIdx.x % SEQ, h = (blockIdx.x / SEQ) % MH, b = blockIdx.x / (SEQ * MH);
    const int tid = threadIdx.x;
    const size_t rowq = (size_t)(b * SEQ + q) * INW;
    if (tid < 64) qs[tid] = bf2f(U[rowq + C_MQ + h * MD + tid]);
    if (tid < 129) btab[tid] = rel_bias[rel_bucket(tid) * 12 + 4 + h];
    const int cur = q / MBLK;
    if (tid < NBLK) {
        const int n = tid;
        float s = 0.f;
        if (n < cur) { for (int d = 0; d < MD; ++d) s += QKF[(size_t)(b * SEQ + q) * 1024 + h * MD + d] * kmean[((size_t)(b * MH + h) * NBLK + n) * MD + d]; }
        else s = -1e30f;
        gate_s[n] = s;
    }
    __syncthreads();
    if (tid == 0) {
        int ns = 0;
        unsigned used = 0u;
        for (int t = 0; t < 3; ++t) {
            int best = 0; float bv = -INFINITY;
            for (int n = 0; n < NBLK; ++n) if (!((used >> n) & 1u) && gate_s[n] > bv) { bv = gate_s[n]; best = n; }
            used |= 1u << best;
            if (best < cur) sel[ns++] = best;
        }
        nsel_s = ns;
    }
    __syncthreads();
    const int ns = nsel_s;
    const int nown = q - cur * MBLK + 1;
    const int ntot = ns * MBLK + nown;
    float mx = -INFINITY;
    for (int i = tid; i < ntot; i += 256) {
        int k;
        if (i < ns * MBLK) k = sel[i / MBLK] * MBLK + (i % MBLK); else k = cur * MBLK + (i - ns * MBLK);
        const bf16_t* kr = U + (size_t)(b * SEQ + k) * INW + C_MK + h * MD;
        float s = 0.f;
        for (int d = 0; d < MD; ++d) s += qs[d] * bf2f(kr[d]);
        int dist = q - k; if (dist > 128) dist = 128;
        s = s * 0.125f + btab[dist];
        lg[i] = s; kpos[i] = k; mx = fmaxf(mx, s);
    }
    mx = block_max(mx, red);
    float l = 0.f;
    for (int i = tid; i < ntot; i += 256) { const float p = expf(lg[i] - mx); lg[i] = p; l += p; }
    l = block_sum(l, red);
    __syncthreads();
    const int d = tid & 63, part = tid >> 6;
    float o = 0.f;
    for (int i = part; i < ntot; i += 4) o += lg[i] * bf2f(U[(size_t)(b * SEQ + kpos[i]) * INW + C_MV + h * MD + d]);
    osum[part][d] = o;
    __syncthreads();
    if (tid < 64) {
        float val = (osum[0][tid] + osum[1][tid] + osum[2][tid] + osum[3][tid]) / l;
        const float gt = bf2f(U[rowq + C_MG + h * MD + tid]);
        val *= gt / (1.0f + expf(-gt));
        mix[(size_t)(b * SEQ + q) * 1024 + 512 + h * MD + tid] = f2bf(val);
    }
}

__global__ void k_final(const float* x, const float* g, float* out) {
    __shared__ float red[8];
    const int m = blockIdx.x;
    float v[4]; float s = 0.f;
    for (int i = 0; i < 4; ++i) { v[i] = out[(size_t)m * DM + threadIdx.x + i * 256]; s += v[i] * v[i]; }
    s = block_sum(s, red);
    const float rn = 1.0f / sqrtf(s / DM + 1e-6f);
    for (int i = 0; i < 4; ++i) { const int c = threadIdx.x + i * 256; out[(size_t)m * DM + c] = x[(size_t)m * DM + c] + v[i] * rn * g[c]; }
}

extern "C" void kernel_launch(void* const* d_in, const int* in_sizes, int n_in, void* d_out, int out_size, void* d_ws, size_t ws_size, hipStream_t stream) {
    const float* x = (const float*)d_in[0];
    const float* g_pre = (const float*)d_in[1];
    const float* w_in = (const float*)d_in[2];
    const float* lam = (const float*)d_in[3];
    const float* subg = (const float*)d_in[4];
    const float* w_out = (const float*)d_in[5];
    const float* g_post = (const float*)d_in[6];
    const float* rel_bias = (const float*)d_in[7];
    float* out = (float*)d_out;
    unsigned char* ws = (unsigned char*)d_ws;
    bf16_t* U = (bf16_t*)ws;
    float* QKF = (float*)(ws + ((size_t)128 << 20));
    bf16_t* mix = (bf16_t*)(ws + ((size_t)192 << 20));
    float* rs = (float*)(ws + ((size_t)224 << 20));
    float* kmean = (float*)(ws + ((size_t)225 << 20));
    k_rowscale<<<M, 256, 0, stream>>>(x, rs);
    k_gemm<0><<<dim3(INW / 128, M / 128), 256, 0, stream>>>(x, g_pre, rs, w_in, DM, INW, U, QKF, nullptr);
    k_kmean<<<BATCH * MH * NBLK, 64, 0, stream>>>(QKF, kmean);
    k_diff<<<BATCH * DH * SEQ, 256, 0, stream>>>(U, lam, subg, rel_bias, mix);
    k_moba<<<BATCH * MH * SEQ, 256, 0, stream>>>(U, QKF, kmean, rel_bias, mix);
    k_gemm<1><<<dim3(DM / 128, M / 128), 256, 0, stream>>>(mix, nullptr, nullptr, w_out, 1024, DM, nullptr, nullptr, out);
    k_final<<<M, 256, 0, stream>>>(x, g_post, out);
}
```
